# Optimizing an MI355X kernel written in HIP

```python
import jax, jax.numpy as jnp
from jax import lax
import numpy as np

D_MODEL = 1024
BATCH = 8
SEQ = 2048
DEPTH = 1

CTX_LEN = 256
GRID_W = 64
D_FF = ((8 * D_MODEL // 3 + 255) // 256) * 256
D_FOURIER = D_MODEL // 2
FOURIER_GROUPS = 4
FOURIER_GROUP_W = D_FOURIER // FOURIER_GROUPS
D_LRU = D_MODEL
LRU_HEADS = 8
LRU_HEAD_W = D_LRU // LRU_HEADS
CONV_W = 4
CONV_LEFT = (CONV_W - 1) // 2
GATE_C = 8.0
N_MOD = 9
EPS = 1e-6
D_IN = D_FOURIER + 2 * D_LRU + 2 * D_MODEL
SPLITS = (D_FOURIER, D_FOURIER + D_LRU, D_FOURIER + 2 * D_LRU, D_FOURIER + 2 * D_LRU + D_MODEL)

kernel_name = "hybrid_fnet_rglru_prefix_dit_layer"


def rms_norm(x, g):
    xf = x.astype(jnp.float32)
    y = xf * lax.rsqrt(jnp.mean(xf * xf, axis=-1, keepdims=True) + EPS)
    return (y * g.astype(jnp.float32)).astype(x.dtype)


def modulate(x, g, shift, scale):
    return rms_norm(x, g) * (1.0 + scale) + shift


def swiglu(h, w_in, w_out):
    gate, up = jnp.split(h @ w_in, 2, axis=-1)
    return (jax.nn.silu(gate) * up) @ w_out


def fourier_latent(f):
    b, L, _ = f.shape
    rows = L // GRID_W
    z = f.astype(jnp.float32).reshape(b, rows, GRID_W, FOURIER_GROUPS, FOURIER_GROUP_W)
    z = jnp.fft.fftn(z, axes=(1, 2, 4), norm="ortho").real
    return z.reshape(b, L, D_FOURIER).astype(f.dtype)


def fourier_context(f):
    b, L, _ = f.shape
    z = f.astype(jnp.float32).reshape(b, L, FOURIER_GROUPS, FOURIER_GROUP_W)
    z = jnp.fft.fftn(z, axes=(1, 3), norm="ortho").real
    return z.reshape(b, L, D_FOURIER).astype(f.dtype)


def dwconv_centred(x, w, b):
    L = x.shape[1]
    xp = jnp.pad(x, ((0, 0), (CONV_LEFT, CONV_W - 1 - CONV_LEFT), (0, 0)))
    y = b
    for k in range(CONV_W):
        y = y + xp[:, k:k + L] * w[k]
    return y


def block_diag(x, w, b):
    bsz, L, C = x.shape
    xh = x.reshape(bsz, L, LRU_HEADS, LRU_HEAD_W)
    return jnp.einsum("blhi,hij->blhj", xh, w).reshape(bsz, L, C) + b


def linear_scan(a, b, h0):
    b = b.at[:, 0].add(a[:, 0] * h0)

    def combine(left, right):
        return (left[0] * right[0], right[0] * left[1] + right[1])

    _, h = lax.associative_scan(combine, (a, b), axis=1)
    return h


def rglru_direction(xc, w_r, b_r, w_i, b_i, lam, h0, reverse):
    if reverse:
        xc = jnp.flip(xc, axis=1)
    r = jax.nn.sigmoid(block_diag(xc, w_r, b_r)).astype(jnp.float32)
    i = jax.nn.sigmoid(block_diag(xc, w_i, b_i)).astype(jnp.float32)
    log_a = -GATE_C * r * jax.nn.softplus(-lam.astype(jnp.float32))
    a = jnp.exp(log_a)
    bterm = jnp.sqrt(-jnp.expm1(2.0 * log_a)) * (i * xc.astype(jnp.float32))
    h = linear_scan(a, bterm, h0)
    h_last = h[:, -1]
    if reverse:
        h = jnp.flip(h, axis=1)
    return h, h_last


def mixer(hx, hc, w_in, conv_w, conv_b, w_r, b_r, w_i, b_i, lam, w_fa, w_fb, w_out, need_ctx_out):
    fx, lx, gx, gax, gbx = jnp.split(hx @ w_in, SPLITS, axis=-1)
    fc, lc, gc, gac, gbc = jnp.split(hc @ w_in, SPLITS, axis=-1)

    xcx = dwconv_centred(lx, conv_w, conv_b)
    xcc = dwconv_centred(lc, conv_w, conv_b)
    h0 = jnp.zeros((xcc.shape[0], D_LRU), jnp.float32)
    hcf, hcf_last = rglru_direction(xcc, w_r[0], b_r[0], w_i[0], b_i[0], lam[0], h0, False)
    hcb, hcb_last = rglru_direction(xcc, w_r[1], b_r[1], w_i[1], b_i[1], lam[1], h0, True)
    hxf, _ = rglru_direction(xcx, w_r[0], b_r[0], w_i[0], b_i[0], lam[0], hcf_last, False)
    hxb, _ = rglru_direction(xcx, w_r[1], b_r[1], w_i[1], b_i[1], lam[1], hcb_last, True)

    yb_x = ((hxf + hxb).astype(hx.dtype) * jax.nn.gelu(gx)) @ w_fb
    ya_x = fourier_latent(fx) @ w_fa
    out_x = (jax.nn.sigmoid(gax) * ya_x + jax.nn.sigmoid(gbx) * yb_x) @ w_out
    if not need_ctx_out:
        return out_x, None
    yb_c = ((hcf + hcb).astype(hc.dtype) * jax.nn.gelu(gc)) @ w_fb
    ya_c = fourier_context(fc) @ w_fa
    out_c = (jax.nn.sigmoid(gac) * ya_c + jax.nn.sigmoid(gbc) * yb_c) @ w_out
    return out_x, out_c


def setup_inputs(seed: int = 0) -> dict:
    key = jax.random.key(seed)
    ks = jax.random.split(key, 24)
    D, L = D_MODEL, DEPTH

    def nrm(k, shape, fan_in):
        return jax.random.normal(k, shape, jnp.float32) * (fan_in ** -0.5)

    a0 = jax.random.uniform(ks[19], (L, 2, D_LRU), jnp.float32, 0.9, 0.999)
    s = a0 ** (1.0 / GATE_C)
    lam = jnp.log(s) - jnp.log1p(-s)
    return {
        "x": jax.random.normal(ks[0], (BATCH, SEQ, D), jnp.float32),
        "c": jax.random.normal(ks[1], (BATCH, D), jnp.float32),
        "ctx": jax.random.normal(ks[2], (BATCH, CTX_LEN, D), jnp.float32),
        "c_ctx": jax.random.normal(ks[3], (D,), jnp.float32),
        "w_ada": nrm(ks[4], (L, D, N_MOD * D), D),
        "b_ada": 0.01 * jax.random.normal(ks[5], (L, N_MOD * D), jnp.float32),
        "norm_g": 1.0 + 0.05 * jax.random.normal(ks[6], (L, 6, D), jnp.float32),
        "w_ffn1_in": nrm(ks[7], (L, D, 2 * D_FF), D),
        "w_ffn1_out": nrm(ks[8], (L, D_FF, D), D_FF),
        "w_ffn2_in": nrm(ks[9], (L, D, 2 * D_FF), D),
        "w_ffn2_out": nrm(ks[10], (L, D_FF, D), D_FF),
        "w_in": nrm(ks[11], (L, D, D_IN), D),
        "conv_w": nrm(ks[12], (L, CONV_W, D_LRU), CONV_W),
        "conv_b": 0.01 * jax.random.normal(ks[13], (L, D_LRU), jnp.float32),
        "w_r": nrm(ks[14], (L, 2, LRU_HEADS, LRU_HEAD_W, LRU_HEAD_W), LRU_HEAD_W),
        "b_r": 0.01 * jax.random.normal(ks[15], (L, 2, D_LRU), jnp.float32),
        "w_i": nrm(ks[16], (L, 2, LRU_HEADS, LRU_HEAD_W, LRU_HEAD_W), LRU_HEAD_W),
        "b_i": 0.01 * jax.random.normal(ks[17], (L, 2, D_LRU), jnp.float32),
        "lam": lam,
        "w_fa": nrm(ks[20], (L, D_FOURIER, D), D_FOURIER),
        "w_fb": nrm(ks[21], (L, D_LRU, D), D_LRU),
        "w_out": nrm(ks[22], (L, D, D), D),
    }


def reference(x, c, ctx, c_ctx, w_ada, b_ada, norm_g, w_ffn1_in, w_ffn1_out, w_ffn2_in, w_ffn2_out,
              w_in, conv_w, conv_b, w_r, b_r, w_i, b_i, lam, w_fa, w_fb, w_out):
    sc = jax.nn.silu(c)
    sc_ctx = jax.nn.silu(c_ctx)
    for l in range(DEPTH):
        last = l == DEPTH - 1
        g = norm_g[l]
        mod_x = jnp.split((sc @ w_ada[l] + b_ada[l])[:, None, :], N_MOD, axis=-1)
        mod_c = jnp.split((sc_ctx @ w_ada[l] + b_ada[l])[None, None, :], N_MOD, axis=-1)
        sh1x, sc1x, ga1x, sh2x, sc2x, ga2x, sh3x, sc3x, ga3x = mod_x
        sh1c, sc1c, ga1c, sh2c, sc2c, ga2c, sh3c, sc3c, ga3c = mod_c

        x = x + 0.5 * ga1x * rms_norm(swiglu(modulate(x, g[0], sh1x, sc1x), w_ffn1_in[l], w_ffn1_out[l]), g[1])
        ctx = ctx + 0.5 * ga1c * rms_norm(swiglu(modulate(ctx, g[0], sh1c, sc1c), w_ffn1_in[l], w_ffn1_out[l]), g[1])

        mx, mc = mixer(modulate(x, g[2], sh2x, sc2x), modulate(ctx, g[2], sh2c, sc2c),
                       w_in[l], conv_w[l], conv_b[l], w_r[l], b_r[l], w_i[l], b_i[l], lam[l],
                       w_fa[l], w_fb[l], w_out[l], not last)
        x = x + ga2x * rms_norm(mx, g[3])

        x = x + 0.5 * ga3x * rms_norm(swiglu(modulate(x, g[4], sh3x, sc3x), w_ffn2_in[l], w_ffn2_out[l]), g[5])
        if not last:
            ctx = ctx + ga2c * rms_norm(mc, g[3])
            ctx = ctx + 0.5 * ga3c * rms_norm(swiglu(modulate(ctx, g[4], sh3c, sc3c), w_ffn2_in[l], w_ffn2_out[l]), g[5])
    return x
```

```cpp
#include <hip/hip_runtime.h>
#include <hip/hip_cooperative_groups.h>
#include <cstdio>
#include <cstdint>
namespace cg = cooperative_groups;

#ifndef PHMASK
#define PHMASK 0x7fff
#endif
#ifndef DBG_STOP
#define DBG_STOP -1
#endif
#ifndef DBG_DUMP
#define DBG_DUMP 0
#endif
#ifndef USE_CG_SYNC
#define USE_CG_SYNC 1
#endif
#ifndef MK_N_LAUNCHES
#define MK_N_LAUNCHES 1
#endif

namespace pg8 {
#define PG8_LAS __attribute__((address_space(3)))
typedef unsigned short bf16_t;
typedef short bf16x8 __attribute__((ext_vector_type(8)));
typedef float f32x4 __attribute__((ext_vector_type(4)));
typedef unsigned u32x4 __attribute__((ext_vector_type(4)));
constexpr int BM = 256, BK = 64, HALF = 128, HTB = HALF * BK * 2, STAGE_BYTES = 8 * HTB, NXCD = 8, WGM = 8;

__host__ __device__ __forceinline__ int lds_byte(int r, int c) { const int st = (r >> 4) * 2 + (c >> 5), rr = r & 15, cc = c & 31, ob = rr * 64 + cc * 2; return st * 1024 + (ob ^ (((ob >> 9) & 1) << 5)); }
__host__ __device__ __forceinline__ void stage_rc(int b, int& R, int& C) { const int st = b / 1024, sb = b % 1024, swz = sb ^ (((sb >> 9) & 1) << 5); R = (st >> 1) * 16 + swz / 64; C = (st & 1) * 32 + (swz % 64) / 2; }
__host__ __device__ __forceinline__ int perm32(int rho) { const int n = rho >> 4, i = rho & 15; return 8 * (i >> 2) + 4 * n + (i & 3); }

struct Unit { int pm, pn; };
struct Gemm { const bf16_t* A; const bf16_t* Bt; int M, N, K; };

struct StaticOrder {
    int nM, nN, nwg, G, c;
    __host__ __device__ void init(int M, int N, int G_, int c_) { nM = M / BM; nN = N / BM; nwg = nM * nN; G = G_; c = c_; }
    __host__ __device__ bool next(int i, Unit& u) const {
        const long L = (long)i * G + c; if (L >= nwg) return false;
        int wgid = (int)L; { const int q = nwg / NXCD, r = nwg % NXCD, xcd = wgid % NXCD, off = wgid / NXCD; wgid = (xcd < r ? xcd * (q + 1) : r * (q + 1) + (xcd - r) * q) + off; }
        const int nig = WGM * nN, gid = wgid / nig, fm = gid * WGM, gsz = (nM - fm) < WGM ? (nM - fm) : WGM;
        u.pm = fm + ((wgid % nig) % gsz); u.pn = (wgid % nig) / gsz; return true;
    }
    __device__ __forceinline__ void a_ready(const Unit&) const {}
    __device__ __forceinline__ void done(const Unit&) const {}
};
struct WinOrder {
    StaticOrder so; int G, c;
    __host__ __device__ void init(int G_, int c_) { so.init(64 * 256, 20 * 256, G_, c_); G = G_; c = c_; }
    __host__ __device__ bool next(int i, Unit& u) const {
        const long L = (long)i * G + c;
        if (L < 1280) return so.next(i, u);
        const int e = (int)(L - 1280); if (e >= 32) return false;
        u.pm = 64 + (e >> 2); u.pn = 4 + (e & 3); return true;
    }
    __device__ __forceinline__ void a_ready(const Unit&) const {}
    __device__ __forceinline__ void done(const Unit&) const {}
};

typedef float f32x2v __attribute__((ext_vector_type(2)));
typedef __bf16 bf16x2v __attribute__((ext_vector_type(2)));
__device__ __forceinline__ unsigned cvt_pk_bf16(float lo, float hi) { const f32x2v v = {lo, hi}; return __builtin_bit_cast(unsigned, __builtin_convertvector(v, bf16x2v)); }
__device__ __forceinline__ float bf_lo(unsigned w) { return __uint_as_float(w << 16); }
__device__ __forceinline__ float bf_hi(unsigned w) { return __uint_as_float(w & 0xffff0000u); }
__device__ __forceinline__ float sigm(float x) { return __builtin_amdgcn_rcpf(1.f + __builtin_amdgcn_exp2f(-1.4426950409f * x)); }
__device__ __forceinline__ float silu_f(float x) { return x * sigm(x); }
__device__ __forceinline__ float gelu_tanh_f(float x) { const float u = x * (1.f + 0.044715f * x * x); return x * __builtin_amdgcn_rcpf(1.f + __builtin_amdgcn_exp2f(-2.3022081985f * u)); }

struct EpiSwiglu {
    static constexpr bool PERM = true, AFTER_DRAIN = false;
    bf16_t* O; int ldc;
    __device__ __forceinline__ void operator()(const f32x4 (&acc)[2][2][4][2], const Unit& u, int wr, int wc, int fr, int fq) const {
        const int row0 = u.pm * BM + wr * 64 + fr, col0 = u.pn * HALF + wc * 32 + 8 * fq;
#pragma unroll
        for (int ai = 0; ai < 2; ++ai)
#pragma unroll
            for (int m = 0; m < 4; ++m) {
                bf16_t* rowp = O + (size_t)(row0 + ai * HALF + m * 16) * ldc + col0;
                const f32x4 g0 = acc[ai][0][m][0], g1 = acc[ai][0][m][1], u0 = acc[ai][1][m][0], u1 = acc[ai][1][m][1];
                u32x4 w;
                w.x = cvt_pk_bf16(silu_f(g0[0]) * u0[0], silu_f(g0[1]) * u0[1]); w.y = cvt_pk_bf16(silu_f(g0[2]) * u0[2], silu_f(g0[3]) * u0[3]);
                w.z = cvt_pk_bf16(silu_f(g1[0]) * u1[0], silu_f(g1[1]) * u1[1]); w.w = cvt_pk_bf16(silu_f(g1[2]) * u1[2], silu_f(g1[3]) * u1[3]);
                *(u32x4*)rowp = w;
            }
    }
};
struct EpiYSsq {
    static constexpr bool PERM = true, AFTER_DRAIN = false;
    bf16_t* Y; int ldc; float* part;
    __device__ __forceinline__ void operator()(const f32x4 (&acc)[2][2][4][2], const Unit& u, int wr, int wc, int fr, int fq) const {
        const int row0 = u.pm * BM + wr * 64 + fr, col0 = u.pn * BM + wc * 32 + 8 * fq;
#pragma unroll
        for (int ai = 0; ai < 2; ++ai)
#pragma unroll
            for (int m = 0; m < 4; ++m) {
                const int r = row0 + ai * HALF + m * 16; bf16_t* rowp = Y + (size_t)r * ldc + col0; float s = 0.f;
#pragma unroll
                for (int bj = 0; bj < 2; ++bj) {
                    const f32x4 v0 = acc[ai][bj][m][0], v1 = acc[ai][bj][m][1];
                    s += (v0[0] * v0[0] + v0[1] * v0[1]) + (v0[2] * v0[2] + v0[3] * v0[3]) + (v1[0] * v1[0] + v1[1] * v1[1]) + (v1[2] * v1[2] + v1[3] * v1[3]);
                    u32x4 w; w.x = cvt_pk_bf16(v0[0], v0[1]); w.y = cvt_pk_bf16(v0[2], v0[3]); w.z = cvt_pk_bf16(v1[0], v1[1]); w.w = cvt_pk_bf16(v1[2], v1[3]);
                    *(u32x4*)(rowp + bj * HALF) = w;
                }
                s += __shfl_xor(s, 16); s += __shfl_xor(s, 32);
                if (fq == 0) part[(size_t)r * 16 + u.pn * 4 + wc] = s;
            }
    }
};
struct EpiWin {
    static constexpr bool PERM = true, AFTER_DRAIN = false;
    bf16_t* O[5];
    __device__ __forceinline__ void operator()(const f32x4 (&acc)[2][2][4][2], const Unit& u, int wr, int wc, int fr, int fq) const {
        const int sect = u.pn >> 2; bf16_t* base = O[0];
        if (sect == 1) base = O[1]; else if (sect == 2) base = O[2]; else if (sect == 3) base = O[3]; else if (sect == 4) base = O[4];
        const int row0 = u.pm * BM + wr * 64 + fr, col0 = (u.pn & 3) * BM + wc * 32 + 8 * fq;
#pragma unroll
        for (int ai = 0; ai < 2; ++ai)
#pragma unroll
            for (int m = 0; m < 4; ++m) {
                bf16_t* rowp = base + (size_t)(row0 + ai * HALF + m * 16) * 1024 + col0;
#pragma unroll
                for (int bj = 0; bj < 2; ++bj) {
                    f32x4 v0 = acc[ai][bj][m][0], v1 = acc[ai][bj][m][1];
                    if (sect == 2) {
#pragma unroll
                        for (int j = 0; j < 4; ++j) { v0[j] = gelu_tanh_f(v0[j]); v1[j] = gelu_tanh_f(v1[j]); }
                    } else if (sect >= 3) {
#pragma unroll
                        for (int j = 0; j < 4; ++j) { v0[j] = sigm(v0[j]); v1[j] = sigm(v1[j]); }
                    }
                    u32x4 w; w.x = cvt_pk_bf16(v0[0], v0[1]); w.y = cvt_pk_bf16(v0[2], v0[3]); w.z = cvt_pk_bf16(v1[0], v1[1]); w.w = cvt_pk_bf16(v1[2], v1[3]);
                    *(u32x4*)(rowp + bj * HALF) = w;
                }
            }
    }
};
template <bool ADD> struct EpiGate {
    static constexpr bool PERM = true, AFTER_DRAIN = false;
    const bf16_t* S; const bf16_t* P; bf16_t* O;
    __device__ __forceinline__ void operator()(const f32x4 (&acc)[2][2][4][2], const Unit& u, int wr, int wc, int fr, int fq) const {
        const int row0 = u.pm * BM + wr * 64 + fr, col0 = u.pn * BM + wc * 32 + 8 * fq;
#pragma unroll
        for (int ai = 0; ai < 2; ++ai)
#pragma unroll
            for (int m = 0; m < 4; ++m) {
                const size_t off = (size_t)(row0 + ai * HALF + m * 16) * 1024 + col0;
#pragma unroll
                for (int bj = 0; bj < 2; ++bj) {
                    const f32x4 v0 = acc[ai][bj][m][0], v1 = acc[ai][bj][m][1];
                    const u32x4 sg = *(const u32x4*)(S + off + bj * HALF);
                    float o[8];
                    o[0] = bf_lo(sg.x) * v0[0]; o[1] = bf_hi(sg.x) * v0[1]; o[2] = bf_lo(sg.y) * v0[2]; o[3] = bf_hi(sg.y) * v0[3];
                    o[4] = bf_lo(sg.z) * v1[0]; o[5] = bf_hi(sg.z) * v1[1]; o[6] = bf_lo(sg.w) * v1[2]; o[7] = bf_hi(sg.w) * v1[3];
                    if (ADD) { const u32x4 pv = *(const u32x4*)(P + off + bj * HALF);
                        o[0] += bf_lo(pv.x); o[1] += bf_hi(pv.x); o[2] += bf_lo(pv.y); o[3] += bf_hi(pv.y); o[4] += bf_lo(pv.z); o[5] += bf_hi(pv.z); o[6] += bf_lo(pv.w); o[7] += bf_hi(pv.w); }
                    u32x4 w; w.x = cvt_pk_bf16(o[0], o[1]); w.y = cvt_pk_bf16(o[2], o[3]); w.z = cvt_pk_bf16(o[4], o[5]); w.w = cvt_pk_bf16(o[6], o[7]);
                    *(u32x4*)(O + off + bj * HALF) = w;
                }
            }
    }
};

template <class Epi, class Sched, bool ALIGN_EPI = false, bool SP2 = false>
__device__ __forceinline__ void gemm_phase(PG8_LAS unsigned char* lds, const Gemm g, const Sched& S, const Epi& E) {
    const int tid = threadIdx.x, wid = __builtin_amdgcn_readfirstlane(tid >> 6), lane = tid & 63, wr = wid >> 2, wc = wid & 3, fr = lane & 15, fq = lane >> 4;
    const int K = g.K, nt = K / BK;
    unsigned voffA[2], voffB[2];
#pragma unroll
    for (int i = 0; i < 2; ++i) { int R, C; stage_rc(tid * 16 + i * 8192, R, C); const int Rb = Epi::PERM ? ((R & ~31) + perm32(R & 31)) : R;
        voffA[i] = (unsigned)(R * K + C) * 2u; voffB[i] = (unsigned)(Rb * K + C) * 2u; }
    const size_t kstep = (size_t)(BK * 2);
    const size_t hstep = (size_t)HALF * K * 2;
    const size_t tstep = 2 * hstep;
    const unsigned ldsw = (unsigned)wid * 1024u;
    const int aoff = lds_byte(wr * 64 + fr, fq * 8), boff = lds_byte(wc * 32 + fr, fq * 8);
#define PG8_SA(b, h) (((b) * 2 + (h)) * HTB)
#define PG8_SB(b, h) ((4 + (b) * 2 + (h)) * HTB)
#define PG8_STAGE(bufoff, gbase, voff) do { _Pragma("unroll") for (int _i = 0; _i < 2; ++_i) \
        __builtin_amdgcn_global_load_lds((const unsigned*)((const char*)(gbase) + (voff)[_i]), (PG8_LAS unsigned*)(lds + (bufoff) + ldsw + _i * 8192), 16, 0, 0); } while (0)
#define PG8_LDA(dst, b, h) do { _Pragma("unroll") for (int m = 0; m < 4; ++m) _Pragma("unroll") for (int k = 0; k < 2; ++k) dst[m][k] = *(const PG8_LAS bf16x8*)(lds + PG8_SA(b, h) + aoff + m * 2048 + k * 1024); } while (0)
#define PG8_LDB(dst, b, h) do { _Pragma("unroll") for (int n = 0; n < 2; ++n) _Pragma("unroll") for (int k = 0; k < 2; ++k) dst[n][k] = *(const PG8_LAS bf16x8*)(lds + PG8_SB(b, h) + boff + n * 2048 + k * 1024); } while (0)
#define PG8_MMA(ai, bj, At, Bt) do { __builtin_amdgcn_s_setprio(1); _Pragma("unroll") for (int m = 0; m < 4; ++m) _Pragma("unroll") for (int n = 0; n < 2; ++n) _Pragma("unroll") for (int k = 0; k < 2; ++k) \
        acc[ai][bj][m][n] = __builtin_amdgcn_mfma_f32_16x16x32_bf16(Bt[n][k], At[m][k], acc[ai][bj][m][n], 0, 0, 0); __builtin_amdgcn_s_setprio(0); } while (0)
#define PG8_WAIT_V(n) asm volatile("s_waitcnt vmcnt(" #n ")" ::: "memory")
#define PG8_WAIT_L(n) asm volatile("s_waitcnt lgkmcnt(" #n ")" ::: "memory")
#define PG8_BAR __builtin_amdgcn_s_barrier()
#define PG8_SCHED __builtin_amdgcn_sched_barrier(0)
    Unit cur, nxt; int ui = 0;
    if (!S.next(0, cur)) return;
    f32x4 acc[2][2][4][2];
#pragma unroll
    for (int a = 0; a < 2; ++a)
#pragma unroll
        for (int b = 0; b < 2; ++b)
#pragma unroll
            for (int m = 0; m < 4; ++m)
#pragma unroll
                for (int n = 0; n < 2; ++n) acc[a][b][m][n] = (f32x4){0.f, 0.f, 0.f, 0.f};
    bf16x8 At[4][2], B0[2][2], B1[2][2];
    const char* cA = (const char*)g.A + (size_t)cur.pm * tstep; const char* cB = (const char*)g.Bt + (size_t)cur.pn * tstep;
    S.a_ready(cur);
    if constexpr (SP2) {
        PG8_STAGE(PG8_SB(0, 0), cB, voffB); PG8_STAGE(PG8_SB(0, 1), cB + hstep, voffB); PG8_STAGE(PG8_SA(0, 0), cA, voffA); PG8_STAGE(PG8_SA(0, 1), cA + hstep, voffA);
        if (wr == 1) PG8_BAR;
        PG8_WAIT_V(2); PG8_BAR;
        PG8_STAGE(PG8_SB(1, 0), cB + kstep, voffB); PG8_STAGE(PG8_SA(1, 0), cA + kstep, voffA); PG8_STAGE(PG8_SB(1, 1), cB + hstep + kstep, voffB);
        PG8_WAIT_V(6); PG8_BAR;
    } else {
        PG8_STAGE(PG8_SB(0, 0), cB, voffB); PG8_STAGE(PG8_SA(0, 0), cA, voffA); PG8_STAGE(PG8_SB(0, 1), cB + hstep, voffB); PG8_STAGE(PG8_SA(0, 1), cA + hstep, voffA);
        if (wr == 1) PG8_BAR;
        PG8_WAIT_V(4); PG8_BAR;
        PG8_STAGE(PG8_SB(1, 0), cB + kstep, voffB); PG8_STAGE(PG8_SA(1, 0), cA + kstep, voffA); PG8_STAGE(PG8_SB(1, 1), cB + hstep + kstep, voffB);
        PG8_WAIT_V(6); PG8_BAR;
    }
    for (;;) {
        const bool has_next = S.next(ui + 1, nxt);
        const char* nA = has_next ? (const char*)g.A + (size_t)nxt.pm * tstep : cA; const char* nB = has_next ? (const char*)g.Bt + (size_t)nxt.pn * tstep : cB;
        for (int t = 0; t < nt; t += 2) {
            const bool last = (t == nt - 2);
            const char* a1 = cA + (size_t)(t + 1) * kstep;
            const char* a2 = last ? nA : cA + (size_t)(t + 2) * kstep; const char* b2 = last ? nB : cB + (size_t)(t + 2) * kstep;
            const char* a3 = a2 + kstep; const char* b3 = b2 + kstep;
            if (last && has_next) S.a_ready(nxt);
            if constexpr (SP2) {
            PG8_LDB(B0, 0, 0); PG8_LDB(B1, 0, 1); PG8_SCHED; PG8_LDA(At, 0, 0); PG8_STAGE(PG8_SA(1, 1), a1 + hstep, voffA);
            PG8_WAIT_V(8); PG8_WAIT_L(0); PG8_BAR; PG8_MMA(0, 0, At, B0); PG8_MMA(0, 1, At, B1); PG8_BAR; PG8_SCHED;
            PG8_LDA(At, 0, 1); PG8_STAGE(PG8_SB(0, 0), b2, voffB); PG8_STAGE(PG8_SB(0, 1), b2 + hstep, voffB); PG8_STAGE(PG8_SA(0, 0), a2, voffA);
            PG8_WAIT_V(8); PG8_WAIT_L(0); PG8_BAR; PG8_MMA(1, 0, At, B0); PG8_MMA(1, 1, At, B1); PG8_BAR; PG8_SCHED;
            PG8_LDB(B0, 1, 0); PG8_LDB(B1, 1, 1); PG8_SCHED; PG8_LDA(At, 1, 0); PG8_STAGE(PG8_SA(0, 1), a2 + hstep, voffA);
            PG8_WAIT_V(8); PG8_WAIT_L(0); PG8_BAR; PG8_MMA(0, 0, At, B0); PG8_MMA(0, 1, At, B1); PG8_BAR; PG8_SCHED;
            PG8_LDA(At, 1, 1); PG8_STAGE(PG8_SB(1, 0), b3, voffB); PG8_STAGE(PG8_SB(1, 1), b3 + hstep, voffB); PG8_STAGE(PG8_SA(1, 0), a3, voffA);
            PG8_WAIT_V(8); PG8_WAIT_L(0); PG8_BAR; PG8_MMA(1, 0, At, B0); PG8_MMA(1, 1, At, B1); PG8_BAR; PG8_SCHED;
            } else {
            PG8_LDB(B0, 0, 0); PG8_SCHED; PG8_LDA(At, 0, 0); PG8_STAGE(PG8_SA(1, 1), a1 + hstep, voffA);
            PG8_WAIT_L(8); PG8_BAR; PG8_WAIT_L(0); PG8_MMA(0, 0, At, B0); PG8_BAR; PG8_SCHED;
            PG8_LDB(B1, 0, 1); PG8_STAGE(PG8_SB(0, 0), b2, voffB);
            PG8_BAR; PG8_WAIT_L(0); PG8_MMA(0, 1, At, B1); PG8_BAR;
            PG8_LDA(At, 0, 1); PG8_STAGE(PG8_SA(0, 0), a2, voffA);
            PG8_BAR; PG8_WAIT_L(0); PG8_MMA(1, 0, At, B0); PG8_BAR; PG8_SCHED;
            PG8_STAGE(PG8_SB(0, 1), b2 + hstep, voffB);
            PG8_WAIT_V(6); PG8_BAR; PG8_MMA(1, 1, At, B1); PG8_BAR;
            PG8_LDB(B0, 1, 0); PG8_SCHED; PG8_LDA(At, 1, 0); PG8_STAGE(PG8_SA(0, 1), a2 + hstep, voffA);
            PG8_WAIT_L(8); PG8_BAR; PG8_WAIT_L(0); PG8_MMA(0, 0, At, B0); PG8_BAR; PG8_SCHED;
            PG8_LDB(B1, 1, 1); PG8_STAGE(PG8_SB(1, 0), b3, voffB);
            PG8_BAR; PG8_WAIT_L(0); PG8_MMA(0, 1, At, B1); PG8_BAR;
            PG8_LDA(At, 1, 1); PG8_STAGE(PG8_SA(1, 0), a3, voffA);
            PG8_BAR; PG8_WAIT_L(0); PG8_MMA(1, 0, At, B0); PG8_BAR; PG8_SCHED;
            PG8_STAGE(PG8_SB(1, 1), b3 + hstep, voffB);
            PG8_WAIT_V(6); PG8_BAR; PG8_MMA(1, 1, At, B1); PG8_BAR;
            }
        }
        if constexpr (ALIGN_EPI) { if (wr == 0) PG8_BAR; }
        if constexpr (!Epi::AFTER_DRAIN) { E(acc, cur, wr, wc, fr, fq); S.done(cur); }
        if (!has_next) break;
#pragma unroll
        for (int a = 0; a < 2; ++a)
#pragma unroll
            for (int b = 0; b < 2; ++b)
#pragma unroll
                for (int m = 0; m < 4; ++m)
#pragma unroll
                    for (int n = 0; n < 2; ++n) acc[a][b][m][n] = (f32x4){0.f, 0.f, 0.f, 0.f};
        cur = nxt; cA = nA; cB = nB; ++ui;
        if constexpr (ALIGN_EPI) { if (wr == 1) PG8_BAR; }
    }
    PG8_WAIT_V(0);
    if constexpr (!ALIGN_EPI) { if (wr == 0) PG8_BAR; }
    PG8_BAR;
#undef PG8_SA
#undef PG8_SB
#undef PG8_STAGE
#undef PG8_LDA
#undef PG8_LDB
#undef PG8_MMA
#undef PG8_WAIT_V
#undef PG8_WAIT_L
#undef PG8_BAR
#undef PG8_SCHED
}
}

constexpr int NWAVES = 8, NTHR = 512;
constexpr int D = 1024, NB = 8, SEQ = 2048, CTXL = 256, ML = NB * SEQ, MC = NB * CTXL, MT = ML + MC, FF = 2816, NIN = 5120, DINW = 4608;
constexpr int NCHUNK = 36;
constexpr float EPS = 1e-6f;
constexpr int NPH = 15;

constexpr size_t MiB = 1u << 20;
constexpr size_t WS_MOD = 0;
constexpr size_t WS_LAC = MiB / 2;
constexpr size_t WS_TP = MiB / 2 + 16384, WS_TQ = WS_TP + 16384, WS_T1 = WS_TQ + 16384;
constexpr size_t WS_SSQ = 1 * MiB;
constexpr size_t WS_AGG = 3 * MiB;
constexpr size_t WS_CTL = 7 * MiB + 768 * 1024, CTL_BYTES = 16384;
constexpr size_t WS_WAIN = 8 * MiB, WS_WAOUT = 19 * MiB;
constexpr size_t WS_WIN = 25 * MiB;
constexpr size_t WS_WG = 35 * MiB, WS_WFA = 36 * MiB, WS_WFB = 37 * MiB, WS_WOUT = 39 * MiB;
constexpr size_t WS_H = 41 * MiB;
constexpr size_t WS_BIG = 77 * MiB;
constexpr size_t WS_ACT = WS_BIG;
constexpr size_t WS_L = WS_BIG, WS_GG = WS_BIG + 36 * MiB, WS_SGA = WS_GG + 32 * MiB, WS_SGB = WS_SGA + 32 * MiB, WS_UV = WS_SGB + 32 * MiB;
constexpr size_t WS_R = WS_UV, WS_Y2 = WS_L, WS_PQ = WS_H;
constexpr size_t WS_END = WS_UV + 32 * MiB;
static_assert(WS_END <= 256 * MiB && WS_ACT + (size_t)MT * FF * 2 <= 256 * MiB, "ws map");

constexpr int LDS_BYTES = 147456, MISC_OFF = 131072 + 320;

#define LAS __attribute__((address_space(3)))
typedef unsigned short bf16;
typedef unsigned v4u __attribute__((ext_vector_type(4)));
typedef unsigned v2u __attribute__((ext_vector_type(2)));
typedef float f32x4 __attribute__((ext_vector_type(4)));
typedef float f32x16 __attribute__((ext_vector_type(16)));
typedef short bf16x8 __attribute__((ext_vector_type(8)));
#define LDS_WAIT() asm volatile("s_waitcnt lgkmcnt(0)" ::: "memory")
using pg8::cvt_pk_bf16; using pg8::bf_lo; using pg8::bf_hi; using pg8::sigm;


#define XB_TMO      128
#define XB_XCNT(j)  (256  + 64 * (j))
#define XB_XSUB(j)  (1280 + 64 * (j))
#define XB_XGEN(j)  (2304 + 64 * (j))
#define XB_TOP      3328
#define XB_TOPGEN   3392
#define XCD_BAR_WORDS 3456
#define XB_SPIN_CAP (1u << 20)
__device__ __forceinline__ unsigned xb_ld(unsigned* p)              { return __hip_atomic_load(p, __ATOMIC_RELAXED, __HIP_MEMORY_SCOPE_AGENT); }
__device__ __forceinline__ unsigned xb_add(unsigned* p, unsigned v) { return __hip_atomic_fetch_add(p, v, __ATOMIC_RELAXED, __HIP_MEMORY_SCOPE_AGENT); }
__device__ __forceinline__ unsigned xb_xcc_id() { return (unsigned)__builtin_amdgcn_s_getreg((3 << 11) | 20) & 0xFu; }
#define XB_SPIN(cond, bar) do { unsigned _sp = 0; while (cond) { __builtin_amdgcn_s_sleep(1); \
    if ((++_sp & 255u) == 0u) { if (xb_ld(&(bar)[XB_TMO])) break; if (_sp > XB_SPIN_CAP) { atomicAdd(&(bar)[XB_TMO], 1u); break; } } } } while (0)
struct XcdBarrier { unsigned* bar; unsigned x; volatile LAS unsigned* st; };
__device__ __forceinline__ XcdBarrier xcd_barrier_post(unsigned* bar, volatile LAS unsigned* st) {
    XcdBarrier b; b.bar = bar; b.x = xb_xcc_id(); b.st = st;
    if (threadIdx.x == 0) (void)xb_add(&bar[XB_XCNT(b.x)], 1u);
    return b;
}
__device__ __forceinline__ void xcd_barrier_complete(unsigned* bar, unsigned x, unsigned& nloc, unsigned& nx) {
    const unsigned G = gridDim.x * gridDim.y * gridDim.z;
    unsigned sum, cnt, mine, sp = 0u;
    for (;;) {
        sum = 0u; cnt = 0u; mine = 0u;
#pragma unroll
        for (unsigned j = 0; j < 16; ++j) { const unsigned c = xb_ld(&bar[XB_XCNT(j)]); sum += c; cnt += (c > 0u) ? 1u : 0u; mine = (j == x) ? c : mine; }
        if (sum == G) break;
        __builtin_amdgcn_s_sleep(1);
        if ((++sp & 255u) == 0u) { if (xb_ld(&bar[XB_TMO])) break; if (sp > XB_SPIN_CAP) { atomicAdd(&bar[XB_TMO], 1u); break; } }
    }
    nloc = mine > 0u ? mine : 1u; nx = cnt > 0u ? cnt : 1u;
}
__device__ __forceinline__ void xcd_barrier(const XcdBarrier& b) {
    asm volatile("s_waitcnt vmcnt(0)" ::: "memory");
    __syncthreads();
    if (threadIdx.x == 0) {
        unsigned* bar = b.bar;
        __builtin_amdgcn_s_waitcnt(0);
        unsigned nloc = b.st[0], nx = b.st[1];
        if (nloc == 0u) { xcd_barrier_complete(bar, b.x, nloc, nx); b.st[0] = nloc; b.st[1] = nx; }
        const unsigned old = xb_add(&bar[XB_XSUB(b.x)], 1u);
        const unsigned gen = old / nloc;
        if (old + 1u == (gen + 1u) * nloc) {
            __builtin_amdgcn_fence(__ATOMIC_RELEASE, "agent");
            asm volatile("s_waitcnt vmcnt(0)" ::: "memory");
            const unsigned og = xb_add(&bar[XB_TOP], 1u);
            const unsigned tg = og / nx;
            if (og + 1u == (tg + 1u) * nx) xb_add(&bar[XB_TOPGEN], 1u);
            else XB_SPIN(xb_ld(&bar[XB_TOPGEN]) == tg, bar);
            __builtin_amdgcn_fence(__ATOMIC_ACQUIRE, "agent");
            xb_add(&bar[XB_XGEN(b.x)], 1u);
            asm volatile("s_waitcnt vmcnt(0)" ::: "memory");
        } else {
            XB_SPIN(xb_ld(&bar[XB_XGEN(b.x)]) == gen, bar);
            __builtin_amdgcn_fence(__ATOMIC_ACQUIRE, "agent");
            asm volatile("s_waitcnt vmcnt(0)" ::: "memory");
        }
    }
    __syncthreads();
}

struct Args { const float* in[22]; float* out; unsigned char* ws; int ph_lo, ph_hi; };
enum { I_X = 0, I_C, I_CTX, I_CCTX, I_WADA, I_BADA, I_NORMG, I_F1IN, I_F1OUT, I_F2IN, I_F2OUT, I_WIN, I_CONVW, I_CONVB, I_WR, I_BR, I_WI, I_BI, I_LAM, I_WFA, I_WFB, I_WOUT };

struct Frame {
    LAS unsigned char* lds; int tid, lane, wave, blk, G;
    const float* in[22]; float* out; unsigned char* ws;
};

__device__ __forceinline__ float wave_sum(float v) {
#pragma unroll
    for (int o = 1; o < 64; o <<= 1) v += __shfl_xor(v, o);
    return v;
}

__device__ __forceinline__ void tr_item(const float* W, int ldw, int scol0, int k0, bf16* WT, int K, int drow0, LAS float* scr, int lane) {
#pragma unroll 8
    for (int i = 0; i < 32; ++i) { const int kk = 2 * i + (lane >> 5); scr[kk * 33 + (lane & 31)] = W[(size_t)(k0 + kk) * ldw + scol0 + (lane & 31)]; }
    LDS_WAIT(); asm volatile("" ::: "memory");
    const int c = lane & 7;
#pragma unroll
    for (int j = 0; j < 4; ++j) { const int n = (lane >> 3) + 8 * j; const LAS float* s = scr + (8 * c) * 33 + n;
        v4u o; o.x = cvt_pk_bf16(s[0 * 33], s[1 * 33]); o.y = cvt_pk_bf16(s[2 * 33], s[3 * 33]); o.z = cvt_pk_bf16(s[4 * 33], s[5 * 33]); o.w = cvt_pk_bf16(s[6 * 33], s[7 * 33]);
        *(v4u*)(WT + (size_t)(drow0 + n) * K + k0 + 8 * c) = o; }
    LDS_WAIT(); asm volatile("" ::: "memory");
}
constexpr int I_FIN = 16 * 176, I_FOUT = 44 * 32;
__device__ __forceinline__ void ffn_weight_items(Frame& F, const float* win, const float* wout, int it0, int gw, int NGW, LAS float* scr) {
    bf16* WIt = (bf16*)(F.ws + WS_WAIN); bf16* WOt = (bf16*)(F.ws + WS_WAOUT);
    for (int it = gw; it < it0 + I_FIN + I_FOUT; it += NGW) {
        int r = it - it0; if (r < 0) continue;
        if (r < I_FIN) { const int kb = r / 176, nb = r % 176, np = 32 * nb, pn = np >> 8, within = np & 255, bj = within >> 7, q = within & 127;
            tr_item(win, 2 * FF, bj * FF + 128 * pn + q, 64 * kb, WIt, D, np, scr, F.lane); continue; }
        r -= I_FIN;
        { const int kb = r / 32, nb = r % 32; tr_item(wout, D, 32 * nb, 64 * kb, WOt, FF, 32 * nb, scr, F.lane); }
    }
}

__device__ __forceinline__ void p0_prologue(Frame& F) {
    if (F.blk < 144) {
        LAS float* scv = (LAS float*)F.lds;
        LAS float* red = (LAS float*)(F.lds + 40960);
        for (int e = F.tid; e < 9 * 1024; e += NTHR) { const int v = e >> 10, k = e & 1023; const float cv = v < 8 ? F.in[I_C][v * 1024 + k] : F.in[I_CCTX][k]; scv[e] = pg8::silu_f(cv); }
        __syncthreads();
        const int col = 64 * F.blk + F.lane; const float* wa = F.in[I_WADA] + col;
        float acc[9];
#pragma unroll
        for (int v = 0; v < 9; ++v) acc[v] = 0.f;
#pragma unroll 8
        for (int kk = 0; kk < 128; ++kk) { const int k = 128 * F.wave + kk; const float wv = wa[(size_t)k * 9216];
#pragma unroll
            for (int v = 0; v < 9; ++v) acc[v] += scv[v * 1024 + k] * wv; }
#pragma unroll
        for (int v = 0; v < 9; ++v) red[(F.wave * 9 + v) * 64 + F.lane] = acc[v];
        __syncthreads();
        for (int e = F.tid; e < 9 * 64; e += NTHR) { const int v = e >> 6, l = e & 63; float s = F.in[I_BADA][64 * F.blk + l];
#pragma unroll
            for (int w = 0; w < 8; ++w) s += red[(w * 9 + v) * 64 + l];
            ((float*)(F.ws + WS_MOD))[v * 9216 + 64 * F.blk + l] = s; }
        __syncthreads();
    }
    LAS float* scr = (LAS float*)(F.lds + F.wave * 16384);
    const int gw = ((F.blk + 112) % F.G) * NWAVES + F.wave, NGW = F.G * NWAVES;
    constexpr int I_WINR = 16 * 128, I_FA = 8 * 32, I_FB = 16 * 32, I_OUT = 16 * 32, I_GATE = 32 * 8, I_FOLD = 1024, I_TAB = 288 + 32;
    constexpr int B0 = I_FIN + I_FOUT, B1 = B0 + I_FOLD, B2 = B1 + I_WINR, B3 = B2 + I_FA, B4 = B3 + I_FB, B5 = B4 + I_OUT, B6 = B5 + I_GATE, B7 = B6 + I_TAB;
    ffn_weight_items(F, F.in[I_F1IN], F.in[I_F1OUT], 0, gw, NGW, scr);
    for (int it = gw; it < B7; it += NGW) {
        if (it < B0) continue;
        if (it < B1) {
            const int r = it - B0, mt = r >> 5, g = (r >> 3) & 3, n0 = (r & 7) * 32, which = n0 >> 7, j = (n0 & 127) + (F.lane & 31), kk = F.lane >> 5;
            LAS float* tab = scr;
            { const float sc = 0.08838834764831845f; tab[F.lane] = cospif((float)F.lane * (1.f / 64.f)) * sc; tab[F.lane + 64] = cospif((float)(F.lane + 64) * (1.f / 64.f)) * sc;
              tab[128 + F.lane] = sinpif((float)F.lane * (1.f / 64.f)) * sc; tab[192 + F.lane] = sinpif((float)(F.lane + 64) * (1.f / 64.f)) * sc; }
            LDS_WAIT(); asm volatile("" ::: "memory");
            const float* arow = F.in[I_WIN] + (size_t)(32 * mt + (F.lane & 31)) * DINW + g * 128 + kk;
            f32x16 acc;
#pragma unroll
            for (int i = 0; i < 16; ++i) acc[i] = 0.f;
#pragma unroll 8
            for (int s = 0; s < 64; ++s) { const int c = 2 * s + kk, idx = (c * j) & 127; const float a = arow[2 * s]; const float b = which ? -tab[128 + idx] : tab[idx];
                acc = __builtin_amdgcn_mfma_f32_32x32x2f32(a, b, acc, 0, 0, 0); }
            bf16* dst = (bf16*)(F.ws + WS_WIN) + (size_t)(which * 512 + g * 128 + j) * D + 32 * mt + 4 * kk;
#pragma unroll
            for (int q = 0; q < 4; ++q) { v2u o; o.x = cvt_pk_bf16(acc[4 * q], acc[4 * q + 1]); o.y = cvt_pk_bf16(acc[4 * q + 2], acc[4 * q + 3]); *(v2u*)(dst + 8 * q) = o; }
            LDS_WAIT(); asm volatile("" ::: "memory");
            continue;
        }
        if (it < B2) { const int r = it - B1, kb = r / 128, nb = r % 128; tr_item(F.in[I_WIN], DINW, 512 + 32 * nb, 64 * kb, (bf16*)(F.ws + WS_WIN), D, 1024 + 32 * nb, scr, F.lane); continue; }
        if (it < B3) { const int r = it - B2, kb = r / 32, nb = r % 32; tr_item(F.in[I_WFA], D, 32 * nb, 64 * kb, (bf16*)(F.ws + WS_WFA), 512, 32 * nb, scr, F.lane); continue; }
        if (it < B4) { const int r = it - B3, kb = r / 32, nb = r % 32; tr_item(F.in[I_WFB], D, 32 * nb, 64 * kb, (bf16*)(F.ws + WS_WFB), D, 32 * nb, scr, F.lane); continue; }
        if (it < B5) { const int r = it - B4, kb = r / 32, nb = r % 32; tr_item(F.in[I_WOUT], D, 32 * nb, 64 * kb, (bf16*)(F.ws + WS_WOUT), D, 32 * nb, scr, F.lane); continue; }
        if (it < B6) {
            const int r = it - B5, mat = r >> 3, sub = r & 7, kb = sub >> 2, nb = sub & 3, d = mat >> 4, gate = (mat >> 3) & 1, head = mat & 7;
            const float* src = (gate ? F.in[I_WI] : F.in[I_WR]) + (size_t)(d * 8 + head) * 16384;
            tr_item(src, 128, 32 * nb, 64 * kb, (bf16*)(F.ws + WS_WG) + (size_t)((d * 2 + gate) * 8 + head) * 16384, 128, 32 * nb, scr, F.lane); continue; }
        {
            const int r = it - B6, e = r * 64 + F.lane;
            if (r < 128) { const int k2 = e >> 7, kk = e & 127, n = kk & 63, m = (k2 * n) & 63; const float cv = cospif((float)m * (1.f / 32.f)) * 0.125f, sv = sinpif((float)m * (1.f / 32.f)) * 0.125f;
                ((bf16*)(F.ws + WS_TP))[e] = (bf16)(cvt_pk_bf16(kk < 64 ? cv : sv, 0.f) & 0xffffu); ((bf16*)(F.ws + WS_TQ))[e] = (bf16)(cvt_pk_bf16(kk < 64 ? cv : -sv, 0.f) & 0xffffu); }
            else if (r < 160) { const int e1 = e - 8192, k1 = e1 >> 6, kk = e1 & 63, n = kk & 31, m = (k1 * n) & 31; const float sc = 0.17677669529663687f;
                const float cv = cospif((float)m * (1.f / 16.f)) * sc, sv = sinpif((float)m * (1.f / 16.f)) * sc;
                ((bf16*)(F.ws + WS_T1))[e1] = (bf16)(cvt_pk_bf16(kk < 32 ? cv : sv, 0.f) & 0xffffu); }
            else if (r < 192) { const int e2 = e - 10240; ((float*)(F.ws + WS_LAC))[e2] = -8.f * log1pf(expf(-F.in[I_LAM][e2])); }
        }
    }
}

struct RowJob { const float* baseL; const float* baseC; const bf16* y; float coef; int gate_sec; const float* gpost; float* xout; const float* gpre; int sc_sec, sh_sec; bf16* h; int nrows; };
__device__ __forceinline__ void row_phase(Frame& F, const RowJob J) {
    const int gw = F.blk * NWAVES + F.wave, NGW = F.G * NWAVES; const float* mod = (const float*)(F.ws + WS_MOD); const float* part = (const float*)(F.ws + WS_SSQ);
    for (int r = gw; r < J.nrows; r += NGW) {
        const int v = r < ML ? (r >> 11) : 8; const float* mv = mod + (size_t)v * 9216;
        const f32x4* bp = (const f32x4*)(r < ML ? J.baseL + (size_t)r * D : J.baseC + (size_t)(r - ML) * D) + F.lane;
        f32x4 x[4];
#pragma unroll
        for (int j = 0; j < 4; ++j) x[j] = bp[64 * j];
        if (J.y) {
            const f32x4* pp = (const f32x4*)(part + (size_t)r * 16); const f32x4 p0 = pp[0], p1 = pp[1], p2 = pp[2], p3 = pp[3];
            const float ss = ((p0[0] + p0[1]) + (p0[2] + p0[3])) + ((p1[0] + p1[1]) + (p1[2] + p1[3])) + ((p2[0] + p2[1]) + (p2[2] + p2[3])) + ((p3[0] + p3[1]) + (p3[2] + p3[3]));
            const float rinv = J.coef / sqrtf(ss * (1.f / D) + EPS);
            const v2u* yp = (const v2u*)(J.y + (size_t)r * D) + F.lane;
#pragma unroll
            for (int j = 0; j < 4; ++j) { const v2u yw = yp[64 * j]; const f32x4 ga = *((const f32x4*)(mv + J.gate_sec * 1024) + F.lane + 64 * j), gp = *((const f32x4*)J.gpost + F.lane + 64 * j);
                x[j][0] += ga[0] * gp[0] * bf_lo(yw.x) * rinv; x[j][1] += ga[1] * gp[1] * bf_hi(yw.x) * rinv; x[j][2] += ga[2] * gp[2] * bf_lo(yw.y) * rinv; x[j][3] += ga[3] * gp[3] * bf_hi(yw.y) * rinv; }
        }
        if (J.xout && r < ML) { f32x4* op = (f32x4*)(J.xout + (size_t)r * D) + F.lane;
#pragma unroll
            for (int j = 0; j < 4; ++j) op[64 * j] = x[j]; }
        if (J.h) {
            float s2 = 0.f;
#pragma unroll
            for (int j = 0; j < 4; ++j) s2 += (x[j][0] * x[j][0] + x[j][1] * x[j][1]) + (x[j][2] * x[j][2] + x[j][3] * x[j][3]);
            const float rstd = 1.f / sqrtf(wave_sum(s2) * (1.f / D) + EPS);
            v2u* hp = (v2u*)(J.h + (size_t)r * D) + F.lane;
#pragma unroll
            for (int j = 0; j < 4; ++j) { const f32x4 g = *((const f32x4*)J.gpre + F.lane + 64 * j), sc = *((const f32x4*)(mv + J.sc_sec * 1024) + F.lane + 64 * j), sh = *((const f32x4*)(mv + J.sh_sec * 1024) + F.lane + 64 * j);
                v2u o; o.x = cvt_pk_bf16(x[j][0] * rstd * g[0] * (1.f + sc[0]) + sh[0], x[j][1] * rstd * g[1] * (1.f + sc[1]) + sh[1]);
                o.y = cvt_pk_bf16(x[j][2] * rstd * g[2] * (1.f + sc[2]) + sh[2], x[j][3] * rstd * g[3] * (1.f + sc[3]) + sh[3]); hp[64 * j] = o; }
        }
    }
}

__device__ __forceinline__ int crow(int reg, int h) { return (reg & 3) + 8 * (reg >> 2) + 4 * h; }
constexpr int XC_STRIDE = 132, XA_STRIDE = 136;
constexpr int SC_XC = 0, SC_XA = 64 * XC_STRIDE * 4, SC_HF = SC_XA + 64 * XA_STRIDE * 2, SC_HB = SC_HF + 64 * XC_STRIDE * 4;
static_assert(SC_HB + 64 * XC_STRIDE * 4 <= 131072, "scan LDS");
template <int PASS, int DIR>
__device__ __forceinline__ void scan_core(Frame& F, int b, int k, int head, LAS float* XC, LAS bf16* XA, LAS float* HO) {
    constexpr int d = DIR;
    const int ct = F.wave & 3, l31 = F.lane & 31, hh = F.lane >> 5, cl = 32 * ct + l31, cgl = head * 128 + cl;
    f32x16 ar[2], ai[2];
#pragma unroll
    for (int i = 0; i < 16; ++i) { ar[0][i] = 0.f; ar[1][i] = 0.f; ai[0][i] = 0.f; ai[1][i] = 0.f; }
    {
        const bf16* wr_ = (const bf16*)(F.ws + WS_WG) + ((size_t)((d * 2 + 0) * 8 + head) * 128 + cl) * 128 + 8 * hh;
        const bf16* wi_ = (const bf16*)(F.ws + WS_WG) + ((size_t)((d * 2 + 1) * 8 + head) * 128 + cl) * 128 + 8 * hh;
#pragma unroll
        for (int s = 0; s < 8; ++s) {
            const bf16x8 br = *(const bf16x8*)(wr_ + 16 * s), bi = *(const bf16x8*)(wi_ + 16 * s);
            const bf16x8 a0 = *(const LAS bf16x8*)(XA + l31 * XA_STRIDE + 16 * s + 8 * hh), a1 = *(const LAS bf16x8*)(XA + (32 + l31) * XA_STRIDE + 16 * s + 8 * hh);
            ar[0] = __builtin_amdgcn_mfma_f32_32x32x16_bf16(a0, br, ar[0], 0, 0, 0); ar[1] = __builtin_amdgcn_mfma_f32_32x32x16_bf16(a1, br, ar[1], 0, 0, 0);
            ai[0] = __builtin_amdgcn_mfma_f32_32x32x16_bf16(a0, bi, ai[0], 0, 0, 0); ai[1] = __builtin_amdgcn_mfma_f32_32x32x16_bf16(a1, bi, ai[1], 0, 0, 0);
        }
    }
    {
        const float brv = F.in[I_BR][d * D + cgl], biv = F.in[I_BI][d * D + cgl], lc = ((const float*)(F.ws + WS_LAC))[d * D + cgl] * 1.4426950409f;
#pragma unroll
        for (int rt = 0; rt < 2; ++rt)
#pragma unroll
            for (int reg = 0; reg < 16; ++reg) {
                const int tau = 32 * rt + crow(reg, hh); const float xcv = XC[tau * XC_STRIDE + cl];
                const float r = sigm(ar[rt][reg] + brv), iv = sigm(ai[rt][reg] + biv);
                const float a = __builtin_amdgcn_exp2f(lc * r); const float om = fmaxf(1.f - a * a, 0.f);
                ar[rt][reg] = a; ai[rt][reg] = sqrtf(om) * iv * xcv;
            }
    }
    float carry = 0.f;
    if (PASS == 3) carry = ((const float*)(F.ws + WS_AGG))[((size_t)((b * 2 + d) * NCHUNK + k) * D + cgl) * 2 + 1];
    float Atot = 1.f, Btot = 0.f, hs = carry;
#pragma unroll
    for (int gi = 0; gi < 8; ++gi) {
        const int G = d == 0 ? gi : 7 - gi, rt = G >> 2, q = G & 3;
        float Al = 1.f, Bl = 0.f;
#pragma unroll
        for (int pi = 0; pi < 4; ++pi) { const int p = d == 0 ? pi : 3 - pi; const float a = ar[rt][4 * q + p], bt = ai[rt][4 * q + p]; Bl = a * Bl + bt; Al *= a; }
        const float Ao = __shfl_xor(Al, 32), Bo = __shfl_xor(Bl, 32);
        const bool first = (d == 0) ? (hh == 0) : (hh == 1);
        const float A1 = first ? Al : Ao, B1 = first ? Bl : Bo, A2 = first ? Ao : Al, B2 = first ? Bo : Bl;
        const float AG = A1 * A2, BG = A2 * B1 + B2;
        if (PASS == 3) {
            float hcur = first ? hs : A1 * hs + B1;
#pragma unroll
            for (int pi = 0; pi < 4; ++pi) { const int p = d == 0 ? pi : 3 - pi; hcur = ar[rt][4 * q + p] * hcur + ai[rt][4 * q + p];
                HO[(32 * rt + 8 * q + 4 * hh + p) * XC_STRIDE + cl] = hcur; }
            hs = AG * hs + BG;
        } else { Btot = AG * Btot + BG; Atot *= AG; }
    }
    if (PASS == 1) { if (hh == 0) { float* ag = (float*)(F.ws + WS_AGG) + ((size_t)((b * 2 + d) * NCHUNK + k) * D + cgl) * 2; *(float2*)ag = make_float2(Atot, Btot); } }
}
template <int PASS>
__device__ __forceinline__ void scan_unit(Frame& F, int b, int k, int head) {
    const bool isctx = k < 4; const int t0 = isctx ? 64 * k : 64 * (k - 4), slen = isctx ? CTXL : SEQ;
    const size_t seqrow = isctx ? (size_t)ML + (size_t)b * CTXL : (size_t)b * SEQ;
    const bf16* Lb = (const bf16*)(F.ws + WS_L);
    LAS float* XC = (LAS float*)(F.lds + SC_XC); LAS bf16* XA = (LAS bf16*)(F.lds + SC_XA); LAS float* HF = (LAS float*)(F.lds + SC_HF); LAS float* HB = (LAS float*)(F.lds + SC_HB);
#pragma unroll
    for (int it = 0; it < 2; ++it) {
        const int item = F.tid + NTHR * it, tau = item >> 4, c8 = (item & 15) * 8, cg = head * 128 + c8;
        float xc[8];
        { const f32x4 b0 = *(const f32x4*)(F.in[I_CONVB] + cg), b1 = *(const f32x4*)(F.in[I_CONVB] + cg + 4);
          xc[0] = b0[0]; xc[1] = b0[1]; xc[2] = b0[2]; xc[3] = b0[3]; xc[4] = b1[0]; xc[5] = b1[1]; xc[6] = b1[2]; xc[7] = b1[3]; }
#pragma unroll
        for (int kk = 0; kk < 4; ++kk) { const int t = t0 + tau + kk - 1;
            if (t >= 0 && t < slen) { const v4u lw = *(const v4u*)(Lb + (seqrow + t) * D + cg);
                const f32x4 w0 = *(const f32x4*)(F.in[I_CONVW] + kk * D + cg), w1 = *(const f32x4*)(F.in[I_CONVW] + kk * D + cg + 4);
                xc[0] += w0[0] * bf_lo(lw.x); xc[1] += w0[1] * bf_hi(lw.x); xc[2] += w0[2] * bf_lo(lw.y); xc[3] += w0[3] * bf_hi(lw.y);
                xc[4] += w1[0] * bf_lo(lw.z); xc[5] += w1[1] * bf_hi(lw.z); xc[6] += w1[2] * bf_lo(lw.w); xc[7] += w1[3] * bf_hi(lw.w); } }
        *(LAS f32x4*)(XC + tau * XC_STRIDE + c8) = (f32x4){xc[0], xc[1], xc[2], xc[3]}; *(LAS f32x4*)(XC + tau * XC_STRIDE + c8 + 4) = (f32x4){xc[4], xc[5], xc[6], xc[7]};
        v4u o; o.x = cvt_pk_bf16(xc[0], xc[1]); o.y = cvt_pk_bf16(xc[2], xc[3]); o.z = cvt_pk_bf16(xc[4], xc[5]); o.w = cvt_pk_bf16(xc[6], xc[7]);
        *(LAS v4u*)(XA + tau * XA_STRIDE + c8) = o;
    }
    __syncthreads();
    if ((F.wave >> 2) == 0) scan_core<PASS, 0>(F, b, k, head, XC, XA, HF); else scan_core<PASS, 1>(F, b, k, head, XC, XA, HB);
    if (PASS == 1) {
        __syncthreads();
    } else {
        __syncthreads();
        bf16* GG = (bf16*)(F.ws + WS_GG);
#pragma unroll
        for (int it = 0; it < 2; ++it) {
            const int item = F.tid + NTHR * it, tau = item >> 4, c8 = (item & 15) * 8;
            bf16* gp = GG + ((size_t)b * SEQ + t0 + tau) * D + head * 128 + c8;
            const v4u gw = *(const v4u*)gp;
            const f32x4 f0 = *(const LAS f32x4*)(HF + tau * XC_STRIDE + c8), f1 = *(const LAS f32x4*)(HF + tau * XC_STRIDE + c8 + 4);
            const f32x4 g0 = *(const LAS f32x4*)(HB + tau * XC_STRIDE + c8), g1 = *(const LAS f32x4*)(HB + tau * XC_STRIDE + c8 + 4);
            v4u o; o.x = cvt_pk_bf16((f0[0] + g0[0]) * bf_lo(gw.x), (f0[1] + g0[1]) * bf_hi(gw.x)); o.y = cvt_pk_bf16((f0[2] + g0[2]) * bf_lo(gw.y), (f0[3] + g0[3]) * bf_hi(gw.y));
            o.z = cvt_pk_bf16((f1[0] + g1[0]) * bf_lo(gw.z), (f1[1] + g1[1]) * bf_hi(gw.z)); o.w = cvt_pk_bf16((f1[2] + g1[2]) * bf_lo(gw.w), (f1[3] + g1[3]) * bf_hi(gw.w));
            *(v4u*)gp = o;
        }
        __syncthreads();
    }
}
__device__ __forceinline__ void scan_combine(Frame& F) {
    const int g = F.blk * NTHR + F.tid; if (g >= NB * 2 * D) return;
    const int c = g & 1023, d = (g >> 10) & 1, b = g >> 11;
    float* base = (float*)(F.ws + WS_AGG) + ((size_t)(b * 2 + d) * NCHUNK * D + c) * 2;
    float2 ab[NCHUNK];
#pragma unroll
    for (int k = 0; k < NCHUNK; ++k) ab[k] = *(const float2*)(base + (size_t)k * D * 2);
    float h = 0.f;
    if (d == 0) {
#pragma unroll
        for (int k = 0; k < NCHUNK; ++k) { base[(size_t)k * D * 2 + 1] = h; h = ab[k].x * h + ab[k].y; }
    } else {
#pragma unroll
        for (int k = 3; k >= 0; --k) { base[(size_t)k * D * 2 + 1] = h; h = ab[k].x * h + ab[k].y; }
#pragma unroll
        for (int k = NCHUNK - 1; k >= 4; --k) { base[(size_t)k * D * 2 + 1] = h; h = ab[k].x * h + ab[k].y; }
    }
}

__device__ __forceinline__ bf16x8 gather8(const LAS bf16* img, int stride) {
    bf16x8 r;
#pragma unroll
    for (int j = 0; j < 8; ++j) r[j] = (short)img[j * stride];
    return r;
}
constexpr int FA_T_STRIDE = 136, FA_X_STRIDE = 136;
constexpr int FA_TP = 0, FA_TQ = 64 * FA_T_STRIDE * 2, FA_XU = 2 * 64 * FA_T_STRIDE * 2, FA_XV = FA_XU + 64 * FA_X_STRIDE * 2;
__device__ __forceinline__ void fourier_a_load_tables(Frame& F) {
    const v4u* tp = (const v4u*)(F.ws + WS_TP); const v4u* tq = (const v4u*)(F.ws + WS_TQ);
    for (int e = F.tid; e < 64 * 16; e += NTHR) { const int r = e >> 4, c = e & 15;
        *(LAS v4u*)(F.lds + FA_TP + (r * FA_T_STRIDE + 8 * c) * 2) = tp[e]; *(LAS v4u*)(F.lds + FA_TQ + (r * FA_T_STRIDE + 8 * c) * 2) = tq[e]; }
}
__device__ __forceinline__ void fourier_a_unit(Frame& F, int b, int n1, int g) {
    const bf16* UV = (const bf16*)(F.ws + WS_UV); const size_t row0 = (size_t)b * SEQ + n1 * 64;
#pragma unroll
    for (int it = 0; it < 4; ++it) { const int e = F.tid + NTHR * it, half = e >> 10, r = (e >> 4) & 63, c = e & 15;
        const v4u v = *(const v4u*)(UV + (row0 + r) * D + half * 512 + g * 128 + 8 * c);
        *(LAS v4u*)(F.lds + (half ? FA_XV : FA_XU) + (r * FA_X_STRIDE + 8 * c) * 2) = v; }
    __syncthreads();
    const int which = F.wave >> 2, ct = F.wave & 3, l31 = F.lane & 31, hh = F.lane >> 5, cl = 32 * ct + l31;
    const LAS bf16* T = (const LAS bf16*)(F.lds + (which ? FA_TQ : FA_TP));
    const LAS bf16* X0 = (const LAS bf16*)(F.lds + (which ? FA_XV : FA_XU));
    const LAS bf16* X1 = (const LAS bf16*)(F.lds + (which ? FA_XU : FA_XV));
    f32x16 acc[2];
#pragma unroll
    for (int i = 0; i < 16; ++i) { acc[0][i] = 0.f; acc[1][i] = 0.f; }
#pragma unroll
    for (int s = 0; s < 8; ++s) {
        const LAS bf16* X = s < 4 ? X0 : X1; const int kb = (s & 3) * 16 + 8 * hh;
        const bf16x8 bfrag = gather8(X + kb * FA_X_STRIDE + cl, FA_X_STRIDE);
        const bf16x8 a0 = *(const LAS bf16x8*)(T + l31 * FA_T_STRIDE + 16 * s + 8 * hh), a1 = *(const LAS bf16x8*)(T + (32 + l31) * FA_T_STRIDE + 16 * s + 8 * hh);
        acc[0] = __builtin_amdgcn_mfma_f32_32x32x16_bf16(a0, bfrag, acc[0], 0, 0, 0); acc[1] = __builtin_amdgcn_mfma_f32_32x32x16_bf16(a1, bfrag, acc[1], 0, 0, 0);
    }
    bf16* PQ = (bf16*)(F.ws + WS_PQ);
#pragma unroll
    for (int rt = 0; rt < 2; ++rt)
#pragma unroll
        for (int reg = 0; reg < 16; ++reg) PQ[(row0 + 32 * rt + crow(reg, hh)) * D + which * 512 + g * 128 + cl] = (bf16)(cvt_pk_bf16(acc[rt][reg], 0.f) & 0xffffu);
    __syncthreads();
}
constexpr int FB_D_STRIDE = 520, FB_T_STRIDE = 72, FB_T1 = 64 * FB_D_STRIDE * 2;
__device__ __forceinline__ void fourier_b_load_tables(Frame& F) {
    const v4u* t1 = (const v4u*)(F.ws + WS_T1);
    for (int e = F.tid; e < 32 * 8; e += NTHR) { const int r = e >> 3, c = e & 7; *(LAS v4u*)(F.lds + FB_T1 + (r * FB_T_STRIDE + 8 * c) * 2) = t1[e]; }
}
__device__ __forceinline__ void fourier_b_unit(Frame& F, int b, int k2) {
    const bf16* PQ = (const bf16*)(F.ws + WS_PQ);
#pragma unroll
    for (int it = 0; it < 8; ++it) { const int e = F.tid + NTHR * it, row = e >> 6, c = e & 63, n1 = row & 31, half = row >> 5;
        const v4u v = *(const v4u*)(PQ + ((size_t)b * SEQ + n1 * 64 + k2) * D + half * 512 + 8 * c);
        *(LAS v4u*)(F.lds + (row * FB_D_STRIDE + 8 * c) * 2) = v; }
    __syncthreads();
    const int l31 = F.lane & 31, hh = F.lane >> 5;
    const LAS bf16* T = (const LAS bf16*)(F.lds + FB_T1); const LAS bf16* Dm = (const LAS bf16*)F.lds;
    f32x16 acc[2];
#pragma unroll
    for (int i = 0; i < 16; ++i) { acc[0][i] = 0.f; acc[1][i] = 0.f; }
#pragma unroll
    for (int s = 0; s < 4; ++s) {
        const bf16x8 a0 = *(const LAS bf16x8*)(T + l31 * FB_T_STRIDE + 16 * s + 8 * hh);
#pragma unroll
        for (int cti = 0; cti < 2; ++cti) { const int cl = 32 * (2 * F.wave + cti) + l31;
            const bf16x8 bfrag = gather8(Dm + (16 * s + 8 * hh) * FB_D_STRIDE + cl, FB_D_STRIDE);
            acc[cti] = __builtin_amdgcn_mfma_f32_32x32x16_bf16(a0, bfrag, acc[cti], 0, 0, 0); }
    }
    bf16* R = (bf16*)(F.ws + WS_R);
#pragma unroll
    for (int cti = 0; cti < 2; ++cti)
#pragma unroll
        for (int reg = 0; reg < 16; ++reg) R[((size_t)b * SEQ + crow(reg, hh) * 64 + k2) * 512 + 32 * (2 * F.wave + cti) + l31] = (bf16)(cvt_pk_bf16(acc[cti][reg], 0.f) & 0xffffu);
    __syncthreads();
}

__global__ void __launch_bounds__(NTHR, 2) mk_fwd(Args args) {
    extern __shared__ __attribute__((aligned(16))) unsigned char lds_raw[];
    Frame F;
    F.lds = (LAS unsigned char*)lds_raw; F.tid = threadIdx.x; F.lane = F.tid & 63; F.wave = __builtin_amdgcn_readfirstlane(F.tid >> 6);
    F.blk = blockIdx.x; F.G = gridDim.x; F.out = args.out; F.ws = args.ws;
#pragma unroll
    for (int i = 0; i < 22; ++i) F.in[i] = args.in[i];
    cg::grid_group grid = cg::this_grid();
    volatile LAS unsigned* MISC = (volatile LAS unsigned*)(F.lds + MISC_OFF);
    if (F.tid < 32) MISC[F.tid] = 0u;
    __syncthreads();
    XcdBarrier bar = xcd_barrier_post((unsigned*)(F.ws + WS_CTL), MISC + 8);
    const float* ng = F.in[I_NORMG];
    bf16* Hb = (bf16*)(F.ws + WS_H); bf16* ACT = (bf16*)(F.ws + WS_ACT);
    const int lo = args.ph_lo, hi = args.ph_hi;
#define PH(k) (((PHMASK >> (k)) & 1) && lo <= (k) && (k) < hi)
#define SEAM(k) do { if (lo <= (k) && (k) + 1 < hi) { if ((k) == 0 && USE_CG_SYNC) { __syncthreads(); grid.sync(); } xcd_barrier(bar); } } while (0)
    if (PH(0)) p0_prologue(F);
    SEAM(0);
    if (PH(1)) { RowJob J{F.in[I_X], F.in[I_CTX], nullptr, 0.f, 0, nullptr, nullptr, ng + 0 * D, 1, 0, Hb, MT}; row_phase(F, J); }
    SEAM(1);
    if (PH(2)) {
        pg8::Gemm g{Hb, (const bf16*)(F.ws + WS_WAIN), MT, 2 * FF, D}; pg8::StaticOrder S; S.init(MT, 2 * FF, F.G, F.blk);
        pg8::EpiSwiglu E{ACT, FF};
        pg8::gemm_phase<pg8::EpiSwiglu, pg8::StaticOrder, true, true>(F.lds, g, S, E);
    }
    SEAM(2);
    if (PH(3)) {
        pg8::Gemm g{ACT, (const bf16*)(F.ws + WS_WAOUT), MT, D, FF}; pg8::StaticOrder S; S.init(MT, D, F.G, F.blk);
        pg8::EpiYSsq E{Hb, D, (float*)(F.ws + WS_SSQ)};
        pg8::gemm_phase<pg8::EpiYSsq, pg8::StaticOrder, true, true>(F.lds, g, S, E);
    }
    SEAM(3);
    if (PH(4)) {
        { LAS float* scr = (LAS float*)(F.lds + F.wave * 16384); ffn_weight_items(F, F.in[I_F2IN], F.in[I_F2OUT], 0, F.blk * NWAVES + F.wave, F.G * NWAVES, scr); }
        RowJob J{F.in[I_X], F.in[I_CTX], Hb, 0.5f, 2, ng + 1 * D, F.out, ng + 2 * D, 4, 3, Hb, MT}; row_phase(F, J);
    }
    SEAM(4);
    if (PH(5)) {
        pg8::Gemm g{Hb, (const bf16*)(F.ws + WS_WIN), MT, NIN, D}; pg8::WinOrder S; S.init(F.G, F.blk);
        pg8::EpiWin E; E.O[0] = (bf16*)(F.ws + WS_UV); E.O[1] = (bf16*)(F.ws + WS_L); E.O[2] = (bf16*)(F.ws + WS_GG); E.O[3] = (bf16*)(F.ws + WS_SGA); E.O[4] = (bf16*)(F.ws + WS_SGB);
        pg8::gemm_phase<pg8::EpiWin, pg8::WinOrder, true, true>(F.lds, g, S, E);
    }
    SEAM(5);
    if (PH(6)) {
        for (int u = F.blk; u < NB * NCHUNK * 8; u += F.G) { const int head = u & 7, k = (u >> 3) % NCHUNK, b = (u >> 3) / NCHUNK; scan_unit<1>(F, b, k, head); }
        fourier_a_load_tables(F);
        for (int u = F.blk; u < NB * 32 * 4; u += F.G) { const int g = u & 3, n1 = (u >> 2) & 31, b = u >> 7; fourier_a_unit(F, b, n1, g); }
    }
    SEAM(6);
    if (PH(7)) {
        scan_combine(F);
        fourier_b_load_tables(F);
        for (int u = F.blk; u < NB * 64; u += F.G) fourier_b_unit(F, u >> 6, u & 63);
    }
    SEAM(7);
    if (PH(8)) {
        {
            pg8::Gemm g{(const bf16*)(F.ws + WS_R), (const bf16*)(F.ws + WS_WFA), ML, D, 512}; pg8::StaticOrder S; S.init(ML, D, F.G, F.blk);
            pg8::EpiGate<false> E{(const bf16*)(F.ws + WS_SGA), nullptr, (bf16*)(F.ws + WS_SGA)};
            pg8::gemm_phase<pg8::EpiGate<false>, pg8::StaticOrder, true, true>(F.lds, g, S, E);
        }
        for (int u = F.blk; u < NB * 32 * 8; u += F.G) { const int head = u & 7, j = (u >> 3) & 31, b = u >> 8; scan_unit<3>(F, b, 4 + j, head); }
    }
    SEAM(8);
    if (PH(9)) {
        pg8::Gemm g{(const bf16*)(F.ws + WS_GG), (const bf16*)(F.ws + WS_WFB), ML, D, D}; pg8::StaticOrder S; S.init(ML, D, F.G, F.blk);
        pg8::EpiGate<true> E{(const bf16*)(F.ws + WS_SGB), (const bf16*)(F.ws + WS_SGA), (bf16*)(F.ws + WS_SGB)};
        pg8::gemm_phase<pg8::EpiGate<true>, pg8::StaticOrder, true, true>(F.lds, g, S, E);
    }
    SEAM(9);
    if (PH(10)) {
        pg8::Gemm g{(const bf16*)(F.ws + WS_SGB), (const bf16*)(F.ws + WS_WOUT), ML, D, D}; pg8::StaticOrder S; S.init(ML, D, F.G, F.blk);
        pg8::EpiYSsq E{(bf16*)(F.ws + WS_Y2), D, (float*)(F.ws + WS_SSQ)};
        pg8::gemm_phase<pg8::EpiYSsq, pg8::StaticOrder, true, true>(F.lds, g, S, E);
    }
    SEAM(10);
    if (PH(11)) { RowJob J{F.out, nullptr, (const bf16*)(F.ws + WS_Y2), 1.0f, 5, ng + 3 * D, F.out, ng + 4 * D, 7, 6, Hb, ML}; row_phase(F, J); }
    SEAM(11);
    if (PH(12)) {
        pg8::Gemm g{Hb, (const bf16*)(F.ws + WS_WAIN), ML, 2 * FF, D}; pg8::StaticOrder S; S.init(ML, 2 * FF, F.G, F.blk);
        pg8::EpiSwiglu E{ACT, FF};
        pg8::gemm_phase<pg8::EpiSwiglu, pg8::StaticOrder, true, true>(F.lds, g, S, E);
    }
    SEAM(12);
    if (PH(13)) {
        pg8::Gemm g{ACT, (const bf16*)(F.ws + WS_WAOUT), ML, D, FF}; pg8::StaticOrder S; S.init(ML, D, F.G, F.blk);
        pg8::EpiYSsq E{Hb, D, (float*)(F.ws + WS_SSQ)};
        pg8::gemm_phase<pg8::EpiYSsq, pg8::StaticOrder, true, true>(F.lds, g, S, E);
    }
    SEAM(13);
    if (PH(14)) { RowJob J{F.out, nullptr, Hb, 0.5f, 8, ng + 5 * D, F.out, nullptr, 0, 0, nullptr, ML}; row_phase(F, J); }
#undef PH
#undef SEAM
#if DBG_STOP >= 0
    {
        xcd_barrier(bar);
        const bf16* bH = (const bf16*)(F.ws + WS_H); const bf16* bL = (const bf16*)(F.ws + WS_L); const bf16* bG = (const bf16*)(F.ws + WS_GG);
        const bf16* bA = (const bf16*)(F.ws + WS_SGA); const bf16* bB = (const bf16*)(F.ws + WS_SGB); const bf16* bU = (const bf16*)(F.ws + WS_UV);
        const float* fagg = (const float*)(F.ws + WS_AGG); const float* fpart = (const float*)(F.ws + WS_SSQ); const float* fmod = (const float*)(F.ws + WS_MOD);
        for (size_t i = (size_t)F.blk * NTHR + F.tid; i < (size_t)ML * D; i += (size_t)F.G * NTHR) {
            float v = 0.f;
            if (DBG_DUMP & 1) v += __uint_as_float((unsigned)bH[i] << 16);
            if (DBG_DUMP & 2) v += __uint_as_float((unsigned)bL[i] << 16);
            if (DBG_DUMP & 4) v += __uint_as_float((unsigned)bG[i] << 16);
            if (DBG_DUMP & 8) v += __uint_as_float((unsigned)bA[i] << 16);
            if (DBG_DUMP & 16) v += __uint_as_float((unsigned)bB[i] << 16);
            if (DBG_DUMP & 32) v += __uint_as_float((unsigned)bU[i] << 16);
            if (DBG_DUMP & 64) v += fagg[i % (size_t)(NB * 2 * NCHUNK * D * 2)];
            if (DBG_DUMP & 128) v += fpart[i % (size_t)(ML * 16)];
            if (DBG_DUMP & 256) v += fmod[i % (size_t)(9 * 9216)];
            if (DBG_DUMP & 512) v += F.out[i];
            if (DBG_DUMP & 1024) v += __uint_as_float((unsigned)((const bf16*)(F.ws + WS_WAIN))[i % (size_t)(8 * 1024 * 1024)] << 16) + __uint_as_float((unsigned)((const bf16*)(F.ws + WS_WIN))[i % (size_t)(8 * 1024 * 1024)] << 16);
            F.out[i] = v;
        }
    }
#endif
}

extern "C" void kernel_launch(void* const* d_in, const int* in_sizes, int n_in, void* d_out, int out_size, void* d_ws, size_t ws_size, hipStream_t stream) {
    static int grid = 0;
    if (grid == 0) {
        if (n_in != 22 || out_size != ML * D || ws_size < WS_END) { fprintf(stderr, "kernel_launch: unexpected shapes (n_in %d, out %d, ws %zu)\n", n_in, out_size, ws_size); grid = -1; return; }
        int dev = 0, cus = 0, per_cu = 0;
        (void)hipGetDevice(&dev); (void)hipDeviceGetAttribute(&cus, hipDeviceAttributeMultiprocessorCount, dev);
        if (hipFuncSetAttribute((const void*)mk_fwd, hipFuncAttributeMaxDynamicSharedMemorySize, LDS_BYTES) != hipSuccess) { fprintf(stderr, "kernel_launch: hipFuncSetAttribute failed\n"); grid = -1; return; }
        if (hipOccupancyMaxActiveBlocksPerMultiprocessor(&per_cu, (const void*)mk_fwd, NTHR, LDS_BYTES) != hipSuccess || per_cu < 1) { fprintf(stderr, "kernel_launch: occupancy query says %d blocks per CU\n", per_cu); per_cu = 1; }
        (void)hipGetLastError();
        grid = cus;
        fprintf(stderr, "kernel_launch: grid %d, occupancy %d per CU\n", grid, per_cu);
    }
    if (grid < 0) return;
    if (hipMemsetAsync((char*)d_ws + WS_CTL, 0, CTL_BYTES, stream) != hipSuccess) { fprintf(stderr, "kernel_launch: memset failed\n"); return; }
    Args a{};
    for (int i = 0; i < 22; ++i) a.in[i] = (const float*)d_in[i];
    a.out = (float*)d_out; a.ws = (unsigned char*)d_ws;
#if MK_N_LAUNCHES == 1
    a.ph_lo = 0; a.ph_hi = (DBG_STOP >= 0) ? DBG_STOP + 1 : NPH;
    void* kargs[] = {&a};
    hipError_t e = hipLaunchCooperativeKernel((const void*)mk_fwd, dim3(grid), dim3(NTHR), kargs, LDS_BYTES, stream);
    if (e != hipSuccess) fprintf(stderr, "kernel_launch: cooperative launch failed: %s\n", hipGetErrorString(e));
#else
    for (int ph = 0; ph < NPH; ++ph) { a.ph_lo = ph; a.ph_hi = ph + 1; hipLaunchKernelGGL(mk_fwd, dim3(grid), dim3(NTHR), LDS_BYTES, stream, a); }
#endif
}
```
